# Optimizing an MI355X kernel written in HIP

```python
import jax, jax.numpy as jnp
from jax import lax
import numpy as np

D_MODEL = 1024
BATCH = 4
SEQ = 8192
DEPTH = 1

CHUNK = 64
MIX_WIDTH = D_MODEL
CONV_WIDTH = MIX_WIDTH // 2
CONV_GROUPS = 8
CONV_K = 3
GMLP_WIDTH = MIX_WIDTH - CONV_WIDTH
GMLP_HEADS = 8
GMLP_HEAD_DIM = GMLP_WIDTH // GMLP_HEADS
GMLP_BLOCK = 128
D_FF = 4 * D_MODEL
IN_PROJ = 3 * CONV_WIDTH + 2 * GMLP_WIDTH
EPS = 1e-6

kernel_name = "hybrid_conv_gmlp_parallel_block"


def rmsnorm(x, g):
    xf = x.astype(jnp.float32)
    y = xf * lax.rsqrt(jnp.mean(xf * xf, axis=-1, keepdims=True) + EPS)
    return (y * g.astype(jnp.float32)).astype(x.dtype)


def layernorm(x, g, b):
    xf = x.astype(jnp.float32)
    mu = jnp.mean(xf, axis=-1, keepdims=True)
    xc = xf - mu
    y = xc * lax.rsqrt(jnp.mean(xc * xc, axis=-1, keepdims=True) + EPS)
    return (y * g.astype(jnp.float32) + b.astype(jnp.float32)).astype(x.dtype)


def causal_depthwise_conv(z, w):
    s = z.shape[1]
    zp = jnp.pad(z, ((0, 0), (CONV_K - 1, 0), (0, 0)))
    y = zp[:, 0:s] * w[:, 0]
    for k in range(1, CONV_K):
        y = y + zp[:, k:k + s] * w[:, k]
    return y


def spatial_gating(v, w_s, b_s):
    bsz, s, _ = v.shape
    nb = s // GMLP_BLOCK
    idx = jnp.arange(GMLP_BLOCK)
    mask = (idx[None, :] // CHUNK) <= (idx[:, None] // CHUNK)
    w = jnp.where(mask[None], w_s, jnp.zeros_like(w_s))
    vb = v.reshape(bsz, nb, GMLP_BLOCK, GMLP_HEADS, GMLP_HEAD_DIM)
    out = jnp.einsum('hij,bnjhd->bnihd', w, vb)
    out = out + jnp.transpose(b_s)[None, None, :, :, None]
    return out.reshape(bsz, s, GMLP_WIDTH)


def setup_inputs(seed: int = 0) -> dict:
    key = jax.random.key(seed)
    ks = jax.random.split(key, 16)
    f32 = jnp.float32
    nrm = lambda k, shape, scale: (jax.random.normal(k, shape, f32) * scale)
    return {
        "x": jax.random.normal(ks[0], (BATCH, SEQ, D_MODEL), f32),
        "norm1_g": 1.0 + nrm(ks[1], (DEPTH, D_MODEL), 0.02),
        "w_in": nrm(ks[2], (DEPTH, D_MODEL, IN_PROJ), D_MODEL ** -0.5),
        "conv_w": nrm(ks[3], (DEPTH, CONV_WIDTH, CONV_K), CONV_K ** -0.5),
        "gmlp_ln_g": 1.0 + nrm(ks[4], (DEPTH, GMLP_WIDTH), 0.02),
        "gmlp_ln_b": nrm(ks[5], (DEPTH, GMLP_WIDTH), 0.02),
        "gmlp_ws": nrm(ks[6], (DEPTH, GMLP_HEADS, GMLP_BLOCK, GMLP_BLOCK), GMLP_BLOCK ** -0.5),
        "gmlp_bs": 1.0 + nrm(ks[7], (DEPTH, GMLP_HEADS, GMLP_BLOCK), 0.02),
        "out_norm_conv_g": 1.0 + nrm(ks[8], (DEPTH, CONV_WIDTH), 0.02),
        "out_norm_gmlp_g": 1.0 + nrm(ks[9], (DEPTH, GMLP_WIDTH), 0.02),
        "w_out": nrm(ks[10], (DEPTH, MIX_WIDTH, D_MODEL), MIX_WIDTH ** -0.5),
        "norm2_g": 1.0 + nrm(ks[11], (DEPTH, D_MODEL), 0.02),
        "w_up": nrm(ks[12], (DEPTH, D_MODEL, D_FF), D_MODEL ** -0.5),
        "w_down": nrm(ks[13], (DEPTH, D_FF, D_MODEL), D_FF ** -0.5),
        "final_g": 1.0 + nrm(ks[14], (D_MODEL,), 0.02),
    }


def reference(x, norm1_g, w_in, conv_w, gmlp_ln_g, gmlp_ln_b, gmlp_ws, gmlp_bs,
              out_norm_conv_g, out_norm_gmlp_g, w_out, norm2_g, w_up, w_down, final_g):
    c = CONV_WIDTH
    for l in range(DEPTH):
        h = rmsnorm(x, norm1_g[l])
        p = jnp.einsum('bsd,de->bse', h, w_in[l])
        b_gate = p[..., 0:c]
        c_gate = p[..., c:2 * c]
        xc = p[..., 2 * c:3 * c]
        u = p[..., 3 * c:3 * c + GMLP_WIDTH]
        v = p[..., 3 * c + GMLP_WIDTH:]
        y_a = b_gate * causal_depthwise_conv(c_gate * xc, conv_w[l])
        v = layernorm(v, gmlp_ln_g[l], gmlp_ln_b[l])
        y_b = u * spatial_gating(v, gmlp_ws[l], gmlp_bs[l])
        y = jnp.concatenate([rmsnorm(y_a, out_norm_conv_g[l]),
                             rmsnorm(y_b, out_norm_gmlp_g[l])], axis=-1)
        x = x + jnp.einsum('bse,ed->bsd', y, w_out[l])
        h2 = rmsnorm(x, norm2_g[l])
        a = jax.nn.relu(jnp.einsum('bsd,df->bsf', h2, w_up[l]))
        x = x + jnp.einsum('bsf,fd->bsd', a * a, w_down[l])
    return rmsnorm(x, final_g)
```

```cpp
#include <hip/hip_runtime.h>
#include <cstdio>
#include <cstdint>
namespace pg8 {
#define PG8_LAS __attribute__((address_space(3)))
typedef unsigned short bf16_t;
typedef short bf16x8 __attribute__((ext_vector_type(8)));
typedef float f32x4 __attribute__((ext_vector_type(4)));
typedef unsigned u32x4 __attribute__((ext_vector_type(4)));
constexpr int BM = 256, BK = 64, HALF = 128, HTB = HALF * BK * 2  , STAGE_BYTES = 8 * HTB, NXCD = 8, WGM = 8;

__host__ __device__ __forceinline__ int lds_byte(int r, int c) { const int st = (r >> 4) * 2 + (c >> 5), rr = r & 15, cc = c & 31, ob = rr * 64 + cc * 2; return st * 1024 + (ob ^ (((ob >> 9) & 1) << 5)); }
__host__ __device__ __forceinline__ void stage_rc(int b, int& R, int& C) { const int st = b / 1024, sb = b % 1024, swz = sb ^ (((sb >> 9) & 1) << 5); R = (st >> 1) * 16 + swz / 64; C = (st & 1) * 32 + (swz % 64) / 2; }
__host__ __device__ __forceinline__ int perm32(int rho) { const int n = rho >> 4, i = rho & 15; return 8 * (i >> 2) + 4 * n + (i & 3); }

struct Unit { int pm, pn; };
struct Gemm { const bf16_t* A; const bf16_t* Bt; int M, N, K; };

struct StaticOrder {
    int nM, nN, nwg, G, c;
    __host__ __device__ void init(int M, int N, int G_, int c_) { nM = M / BM; nN = N / BM; nwg = nM * nN; G = G_; c = c_; }
    __host__ __device__ bool next(int i, Unit& u) const {
        const long L = (long)i * G + c; if (L >= nwg) return false;
        int wgid = (int)L; { const int q = nwg / NXCD, r = nwg % NXCD, xcd = wgid % NXCD, off = wgid / NXCD; wgid = (xcd < r ? xcd * (q + 1) : r * (q + 1) + (xcd - r) * q) + off; }
        const int nig = WGM * nN, gid = wgid / nig, fm = gid * WGM, gsz = (nM - fm) < WGM ? (nM - fm) : WGM;
        u.pm = fm + ((wgid % nig) % gsz); u.pn = (wgid % nig) / gsz; return true;
    }
    __device__ __forceinline__ void a_ready(const Unit&) const {}
    __device__ __forceinline__ void done(const Unit&) const {}
};
__device__ __forceinline__ unsigned cvt_pk_bf16(float lo, float hi) { unsigned r; asm volatile("v_cvt_pk_bf16_f32 %0, %1, %2" : "=v"(r) : "v"(lo), "v"(hi)); return r; }
typedef float f32x2 __attribute__((ext_vector_type(2)));
struct EpiIn {
    static constexpr bool PERM = true, AFTER_DRAIN = false;
    bf16_t* P;
    __device__ __forceinline__ void operator()(const f32x4 (&acc)[2][2][4][2], const Unit& u, int wr, int wc, int fr, int fq) const {
        const int row0 = u.pm * BM + wr * 64 + fr;
        if (u.pn < 4) {
            const int col0 = u.pn * 128 + wc * 32 + 8 * fq;
#pragma unroll
            for (int ai = 0; ai < 2; ++ai)
#pragma unroll
                for (int m = 0; m < 4; ++m) { bf16_t* rowp = P + (size_t)(row0 + ai * HALF + m * 16) * 2048 + col0;
                    const f32x4 v0 = acc[ai][0][m][0] * acc[ai][1][m][0], v1 = acc[ai][0][m][1] * acc[ai][1][m][1];
                    u32x4 w; w.x = cvt_pk_bf16(v0[0], v0[1]); w.y = cvt_pk_bf16(v0[2], v0[3]); w.z = cvt_pk_bf16(v1[0], v1[1]); w.w = cvt_pk_bf16(v1[2], v1[3]);
                    *(u32x4*)rowp = w; }
        } else {
            const int col0 = 512 + (u.pn - 4) * BM + wc * 32 + 8 * fq;
#pragma unroll
            for (int ai = 0; ai < 2; ++ai)
#pragma unroll
                for (int m = 0; m < 4; ++m) { bf16_t* rowp = P + (size_t)(row0 + ai * HALF + m * 16) * 2048 + col0;
#pragma unroll
                    for (int bj = 0; bj < 2; ++bj) { const f32x4 v0 = acc[ai][bj][m][0], v1 = acc[ai][bj][m][1];
                        u32x4 w; w.x = cvt_pk_bf16(v0[0], v0[1]); w.y = cvt_pk_bf16(v0[2], v0[3]); w.z = cvt_pk_bf16(v1[0], v1[1]); w.w = cvt_pk_bf16(v1[2], v1[3]);
                        *(u32x4*)(rowp + bj * HALF) = w; } }
        }
    }
};
template <bool WB> struct EpiRes {
    static constexpr bool PERM = false, AFTER_DRAIN = false;
    const float* base; float* out; bf16_t* xb; float* rowsq;
    __device__ __forceinline__ void operator()(const f32x4 (&acc)[2][2][4][2], const Unit& u, int wr, int wc, int fr, int fq) const {
        const int row0 = u.pm * BM + wr * 64 + fr, col0 = u.pn * BM + wc * 32 + 4 * fq;
#pragma unroll
        for (int ai = 0; ai < 2; ++ai)
#pragma unroll
            for (int m = 0; m < 4; ++m) { const int r = row0 + ai * HALF + m * 16; const size_t off = (size_t)r * 1024 + col0; float ss = 0.f;
#pragma unroll
                for (int bj = 0; bj < 2; ++bj)
#pragma unroll
                    for (int n = 0; n < 2; ++n) { const f32x4 bs = *(const f32x4*)(base + off + bj * HALF + n * 16); const f32x4 o = bs + acc[ai][bj][m][n];
                        *(f32x4*)(out + off + bj * HALF + n * 16) = o;
                        if (WB) { typedef unsigned u32x2v __attribute__((ext_vector_type(2))); u32x2v w; w.x = cvt_pk_bf16(o[0], o[1]); w.y = cvt_pk_bf16(o[2], o[3]); *(u32x2v*)(xb + off + bj * HALF + n * 16) = w; }
                        ss += (o[0] * o[0] + o[1] * o[1]) + (o[2] * o[2] + o[3] * o[3]); }
                ss += __shfl_xor(ss, 16); ss += __shfl_xor(ss, 32);
                if (fq == 0) __hip_atomic_fetch_add(rowsq + r, ss, __ATOMIC_RELAXED, __HIP_MEMORY_SCOPE_AGENT);
                if (m & 1) asm volatile("" ::: "memory"); }
    }
};
struct EpiUp {
    static constexpr bool PERM = true, AFTER_DRAIN = false;
    bf16_t* O; const float* rowsq; float eps;
    __device__ __forceinline__ void operator()(const f32x4 (&acc)[2][2][4][2], const Unit& u, int wr, int wc, int fr, int fq) const {
        const int row0 = u.pm * BM + wr * 64 + fr, col0 = u.pn * BM + wc * 32 + 8 * fq;
        float s[2][4];
#pragma unroll
        for (int ai = 0; ai < 2; ++ai)
#pragma unroll
            for (int m = 0; m < 4; ++m) s[ai][m] = __hip_atomic_load(rowsq + row0 + ai * HALF + m * 16, __ATOMIC_RELAXED, __HIP_MEMORY_SCOPE_AGENT);
#pragma unroll
        for (int ai = 0; ai < 2; ++ai)
#pragma unroll
            for (int m = 0; m < 4; ++m) { bf16_t* rowp = O + (size_t)(row0 + ai * HALF + m * 16) * 4096 + col0; const float sc = 1.0f / (s[ai][m] * (1.0f / 1024.0f) + eps);
#pragma unroll
                for (int bj = 0; bj < 2; ++bj) { f32x4 v0 = acc[ai][bj][m][0], v1 = acc[ai][bj][m][1];
#pragma unroll
                    for (int j = 0; j < 4; ++j) { const float a = fmaxf(v0[j], 0.f), b = fmaxf(v1[j], 0.f); v0[j] = a * a * sc; v1[j] = b * b * sc; }
                    u32x4 w; w.x = cvt_pk_bf16(v0[0], v0[1]); w.y = cvt_pk_bf16(v0[2], v0[3]); w.z = cvt_pk_bf16(v1[0], v1[1]); w.w = cvt_pk_bf16(v1[2], v1[3]);
                    *(u32x4*)(rowp + bj * HALF) = w; } }
    }
};
template <class Epi, class Sched, bool ALIGN_EPI = false, bool SP2 = false>
__device__ __forceinline__ void gemm_phase(PG8_LAS unsigned char* lds, const Gemm g, const Sched& S, const Epi& E) {
    const int tid = threadIdx.x, wid = __builtin_amdgcn_readfirstlane(tid >> 6), lane = tid & 63, wr = wid >> 2, wc = wid & 3, fr = lane & 15, fq = lane >> 4;
    const int K = g.K, nt = K / BK;
    unsigned voffA[2], voffB[2];
#pragma unroll
    for (int i = 0; i < 2; ++i) { int R, C; stage_rc(tid * 16 + i * 8192, R, C); const int Rb = Epi::PERM ? ((R & ~31) + perm32(R & 31)) : R;
        voffA[i] = (unsigned)(R * K + C) * 2u; voffB[i] = (unsigned)(Rb * K + C) * 2u; }
    const size_t kstep = (size_t)(BK * 2);
    const size_t hstep = (size_t)HALF * K * 2;
    const size_t tstep = 2 * hstep;
    const unsigned ldsw = (unsigned)wid * 1024u;
    const int aoff = lds_byte(wr * 64 + fr, fq * 8), boff = lds_byte(wc * 32 + fr, fq * 8);
#define PG8_SA(b, h) (((b) * 2 + (h)) * HTB)
#define PG8_SB(b, h) ((4 + (b) * 2 + (h)) * HTB)
#define PG8_STAGE(bufoff, gbase, voff) do { _Pragma("unroll") for (int _i = 0; _i < 2; ++_i) \
        __builtin_amdgcn_global_load_lds((const unsigned*)((const char*)(gbase) + (voff)[_i]), (PG8_LAS unsigned*)(lds + (bufoff) + ldsw + _i * 8192), 16, 0, 0); } while (0)
#define PG8_LDA(dst, b, h) do { _Pragma("unroll") for (int m = 0; m < 4; ++m) _Pragma("unroll") for (int k = 0; k < 2; ++k) dst[m][k] = *(const PG8_LAS bf16x8*)(lds + PG8_SA(b, h) + aoff + m * 2048 + k * 1024); } while (0)
#define PG8_LDB(dst, b, h) do { _Pragma("unroll") for (int n = 0; n < 2; ++n) _Pragma("unroll") for (int k = 0; k < 2; ++k) dst[n][k] = *(const PG8_LAS bf16x8*)(lds + PG8_SB(b, h) + boff + n * 2048 + k * 1024); } while (0)
#define PG8_MMA(ai, bj, At, Bt) do { __builtin_amdgcn_s_setprio(1); _Pragma("unroll") for (int m = 0; m < 4; ++m) _Pragma("unroll") for (int n = 0; n < 2; ++n) _Pragma("unroll") for (int k = 0; k < 2; ++k) \
        acc[ai][bj][m][n] = __builtin_amdgcn_mfma_f32_16x16x32_bf16(Bt[n][k], At[m][k], acc[ai][bj][m][n], 0, 0, 0); __builtin_amdgcn_s_setprio(0); } while (0)
#define PG8_WAIT_V(n) asm volatile("s_waitcnt vmcnt(" #n ")" ::: "memory")
#define PG8_WAIT_L(n) asm volatile("s_waitcnt lgkmcnt(" #n ")" ::: "memory")
#define PG8_BAR __builtin_amdgcn_s_barrier()
#define PG8_SCHED __builtin_amdgcn_sched_barrier(0)
    Unit cur, nxt; int ui = 0;
    if (!S.next(0, cur)) return;
    f32x4 acc[2][2][4][2];
#pragma unroll
    for (int a = 0; a < 2; ++a)
#pragma unroll
        for (int b = 0; b < 2; ++b)
#pragma unroll
            for (int m = 0; m < 4; ++m)
#pragma unroll
                for (int n = 0; n < 2; ++n) acc[a][b][m][n] = (f32x4){0.f, 0.f, 0.f, 0.f};
    bf16x8 At[4][2], B0[2][2], B1[2][2];
    const char* cA = (const char*)g.A + (size_t)cur.pm * tstep; const char* cB = (const char*)g.Bt + (size_t)cur.pn * tstep;
    S.a_ready(cur);
    if constexpr (SP2) {
        PG8_STAGE(PG8_SB(0, 0), cB, voffB); PG8_STAGE(PG8_SB(0, 1), cB + hstep, voffB); PG8_STAGE(PG8_SA(0, 0), cA, voffA); PG8_STAGE(PG8_SA(0, 1), cA + hstep, voffA);
        if (wr == 1) PG8_BAR;
        PG8_WAIT_V(2); PG8_BAR;
        PG8_STAGE(PG8_SB(1, 0), cB + kstep, voffB); PG8_STAGE(PG8_SA(1, 0), cA + kstep, voffA); PG8_STAGE(PG8_SB(1, 1), cB + hstep + kstep, voffB);
        PG8_WAIT_V(6); PG8_BAR;
    } else {
        PG8_STAGE(PG8_SB(0, 0), cB, voffB); PG8_STAGE(PG8_SA(0, 0), cA, voffA); PG8_STAGE(PG8_SB(0, 1), cB + hstep, voffB); PG8_STAGE(PG8_SA(0, 1), cA + hstep, voffA);
        if (wr == 1) PG8_BAR;
        PG8_WAIT_V(4); PG8_BAR;
        PG8_STAGE(PG8_SB(1, 0), cB + kstep, voffB); PG8_STAGE(PG8_SA(1, 0), cA + kstep, voffA); PG8_STAGE(PG8_SB(1, 1), cB + hstep + kstep, voffB);
        PG8_WAIT_V(6); PG8_BAR;
    }
    for (;;) {
        const bool has_next = S.next(ui + 1, nxt);
        const char* nA = has_next ? (const char*)g.A + (size_t)nxt.pm * tstep : cA; const char* nB = has_next ? (const char*)g.Bt + (size_t)nxt.pn * tstep : cB;
        for (int t = 0; t < nt; t += 2) {
            const bool last = (t == nt - 2);
            const char* a1 = cA + (size_t)(t + 1) * kstep;
            const char* a2 = last ? nA : cA + (size_t)(t + 2) * kstep; const char* b2 = last ? nB : cB + (size_t)(t + 2) * kstep;
            const char* a3 = a2 + kstep; const char* b3 = b2 + kstep;
            if (last && has_next) S.a_ready(nxt);
            if constexpr (SP2) {
            PG8_LDB(B0, 0, 0); PG8_LDB(B1, 0, 1); PG8_SCHED; PG8_LDA(At, 0, 0); PG8_STAGE(PG8_SA(1, 1), a1 + hstep, voffA);
            PG8_WAIT_V(8); PG8_WAIT_L(0); PG8_BAR; PG8_MMA(0, 0, At, B0); PG8_MMA(0, 1, At, B1); PG8_BAR; PG8_SCHED;
            PG8_LDA(At, 0, 1); PG8_STAGE(PG8_SB(0, 0), b2, voffB); PG8_STAGE(PG8_SB(0, 1), b2 + hstep, voffB); PG8_STAGE(PG8_SA(0, 0), a2, voffA);
            PG8_WAIT_V(8); PG8_WAIT_L(0); PG8_BAR; PG8_MMA(1, 0, At, B0); PG8_MMA(1, 1, At, B1); PG8_BAR; PG8_SCHED;
            PG8_LDB(B0, 1, 0); PG8_LDB(B1, 1, 1); PG8_SCHED; PG8_LDA(At, 1, 0); PG8_STAGE(PG8_SA(0, 1), a2 + hstep, voffA);
            PG8_WAIT_V(8); PG8_WAIT_L(0); PG8_BAR; PG8_MMA(0, 0, At, B0); PG8_MMA(0, 1, At, B1); PG8_BAR; PG8_SCHED;
            PG8_LDA(At, 1, 1); PG8_STAGE(PG8_SB(1, 0), b3, voffB); PG8_STAGE(PG8_SB(1, 1), b3 + hstep, voffB); PG8_STAGE(PG8_SA(1, 0), a3, voffA);
            PG8_WAIT_V(8); PG8_WAIT_L(0); PG8_BAR; PG8_MMA(1, 0, At, B0); PG8_MMA(1, 1, At, B1); PG8_BAR; PG8_SCHED;
            } else {
            PG8_LDB(B0, 0, 0); PG8_SCHED; PG8_LDA(At, 0, 0); PG8_STAGE(PG8_SA(1, 1), a1 + hstep, voffA);
            PG8_WAIT_L(8); PG8_BAR; PG8_WAIT_L(0); PG8_MMA(0, 0, At, B0); PG8_BAR; PG8_SCHED;
            PG8_LDB(B1, 0, 1); PG8_STAGE(PG8_SB(0, 0), b2, voffB);
            PG8_BAR; PG8_WAIT_L(0); PG8_MMA(0, 1, At, B1); PG8_BAR;
            PG8_LDA(At, 0, 1); PG8_STAGE(PG8_SA(0, 0), a2, voffA);
            PG8_BAR; PG8_WAIT_L(0); PG8_MMA(1, 0, At, B0); PG8_BAR; PG8_SCHED;
            PG8_STAGE(PG8_SB(0, 1), b2 + hstep, voffB);
            PG8_WAIT_V(6); PG8_BAR; PG8_MMA(1, 1, At, B1); PG8_BAR;
            PG8_LDB(B0, 1, 0); PG8_SCHED; PG8_LDA(At, 1, 0); PG8_STAGE(PG8_SA(0, 1), a2 + hstep, voffA);
            PG8_WAIT_L(8); PG8_BAR; PG8_WAIT_L(0); PG8_MMA(0, 0, At, B0); PG8_BAR; PG8_SCHED;
            PG8_LDB(B1, 1, 1); PG8_STAGE(PG8_SB(1, 0), b3, voffB);
            PG8_BAR; PG8_WAIT_L(0); PG8_MMA(0, 1, At, B1); PG8_BAR;
            PG8_LDA(At, 1, 1); PG8_STAGE(PG8_SA(1, 0), a3, voffA);
            PG8_BAR; PG8_WAIT_L(0); PG8_MMA(1, 0, At, B0); PG8_BAR; PG8_SCHED;
            PG8_STAGE(PG8_SB(1, 1), b3 + hstep, voffB);
            PG8_WAIT_V(6); PG8_BAR; PG8_MMA(1, 1, At, B1); PG8_BAR;
            }
        }
        if constexpr (ALIGN_EPI) { if (wr == 0) PG8_BAR; }
        if constexpr (!Epi::AFTER_DRAIN) { E(acc, cur, wr, wc, fr, fq); S.done(cur); }
        if (!has_next) break;
#pragma unroll
        for (int a = 0; a < 2; ++a)
#pragma unroll
            for (int b = 0; b < 2; ++b)
#pragma unroll
                for (int m = 0; m < 4; ++m)
#pragma unroll
                    for (int n = 0; n < 2; ++n) acc[a][b][m][n] = (f32x4){0.f, 0.f, 0.f, 0.f};
        cur = nxt; cA = nA; cB = nB; ++ui;
        if constexpr (ALIGN_EPI) { if (wr == 1) PG8_BAR; }
    }
    PG8_WAIT_V(0);
    if constexpr (!ALIGN_EPI) { if (wr == 0) PG8_BAR; }
    PG8_BAR;
    if constexpr (Epi::AFTER_DRAIN) { E.fused(acc, cur, wr, wc, fr, fq, lds, wid, lane); S.done(cur); }
#undef PG8_SA
#undef PG8_SB
#undef PG8_STAGE
#undef PG8_LDA
#undef PG8_LDB
#undef PG8_MMA
#undef PG8_WAIT_V
#undef PG8_WAIT_L
#undef PG8_BAR
#undef PG8_SCHED
}
}

constexpr int NWAVES = 8;
#ifndef MK_N_LAUNCHES
#define MK_N_LAUNCHES 7
#endif
constexpr int N_LAUNCHES = MK_N_LAUNCHES;
constexpr int PER_PHASE = 7;

constexpr int M = 32768, D = 1024, SEQ = 8192, NIN = 2560, FF = 4096;
constexpr float EPS = 1e-6f;
constexpr int PW = 2048, P_Z = 0, P_B = 512, P_U = 1024, P_V = 1536;

constexpr size_t MiB = 1u << 20;
constexpr size_t WS_CTL = 0, CTL_ZERO_BYTES = 1 * MiB;
constexpr size_t WS_WIN = 1 * MiB, WS_WOUT = 6 * MiB, WS_WUP = 8 * MiB, WS_WDN = 16 * MiB, WS_WSB = 24 * MiB;
constexpr size_t WS_X1B = 32 * MiB;
constexpr size_t WS_A2 = 96 * MiB;
constexpr size_t WS_H = 96 * MiB, WS_P = 160 * MiB, WS_Y = 288 * MiB, WS_END = 352 * MiB;
constexpr int CW_BAR = 4096;
constexpr size_t CTL_ROWSQ2 = 256 * 1024, CTL_ROWSQ3 = 384 * 1024;
static_assert(CTL_ROWSQ3 + (size_t)M * 4 <= CTL_ZERO_BYTES, "CTL map");

constexpr int RING_OFF = 0, RING_BYTES = 131072;
constexpr int VSTR = 1088;
constexpr int PART_OFF = 128 * VSTR;
constexpr int LDS_BYTES = 147456;
constexpr int MISC_OFF = LDS_BYTES - 512;
static_assert(PART_OFF + 4096 <= MISC_OFF && RING_BYTES <= MISC_OFF, "LDS map");
#define GAS __attribute__((address_space(1)))
#define LAS __attribute__((address_space(3)))
typedef unsigned short bf16;
typedef unsigned v4u __attribute__((ext_vector_type(4)));
typedef float f32x4 __attribute__((ext_vector_type(4)));
typedef short bf16x8 __attribute__((ext_vector_type(8)));
typedef GAS unsigned gu32;
typedef GAS unsigned long long gu64;
#define RLX_AGENT __ATOMIC_RELAXED, __HIP_MEMORY_SCOPE_AGENT
#define LDS_WAIT() asm volatile("s_waitcnt lgkmcnt(0)" ::: "memory")
#define VM_WAIT() asm volatile("s_waitcnt vmcnt(0)" ::: "memory")
__device__ __forceinline__ unsigned long long rt() { return __builtin_amdgcn_s_memrealtime(); }
__device__ __forceinline__ unsigned f2bf(float f) { unsigned u = __builtin_bit_cast(unsigned, f); return (u + 0x7fffu + ((u >> 16) & 1u)) >> 16; }
__device__ __forceinline__ unsigned pk2(float lo, float hi) { return f2bf(lo) | (f2bf(hi) << 16); }

#define XB_TMO      128
#define XB_XCNT(j)  (256  + 64 * (j))
#define XB_XSUB(j)  (1280 + 64 * (j))
#define XB_XGEN(j)  (2304 + 64 * (j))
#define XB_TOP      3328
#define XB_TOPGEN   3392
#define XCD_BAR_WORDS 3456
#define XB_SPIN_CAP (1u << 18)

__device__ __forceinline__ unsigned xb_ld(unsigned* p)              { return __hip_atomic_load(p, __ATOMIC_RELAXED, __HIP_MEMORY_SCOPE_AGENT); }
__device__ __forceinline__ unsigned xb_add(unsigned* p, unsigned v) { return __hip_atomic_fetch_add(p, v, __ATOMIC_RELAXED, __HIP_MEMORY_SCOPE_AGENT); }
__device__ __forceinline__ unsigned xb_xcc_id() { return (unsigned)__builtin_amdgcn_s_getreg((3 << 11) | 20) & 0xFu; }
#define XB_SPIN(cond, bar) do { unsigned _sp = 0; while (cond) { __builtin_amdgcn_s_sleep(1); \
    if ((++_sp & 255u) == 0u) { if (xb_ld(&(bar)[XB_TMO])) break; if (_sp > XB_SPIN_CAP) { atomicAdd(&(bar)[XB_TMO], 1u); break; } } } } while (0)

struct XcdBarrier {
    unsigned* bar; unsigned x;
    volatile LAS unsigned* st;
};

__device__ __forceinline__ XcdBarrier xcd_barrier_post(unsigned* bar, volatile LAS unsigned* st) {
    XcdBarrier b; b.bar = bar; b.x = xb_xcc_id(); b.st = st;
    if (threadIdx.x == 0) (void)xb_add(&bar[XB_XCNT(b.x)], 1u);
    return b;
}
__device__ __forceinline__ void xcd_barrier_complete(unsigned* bar, unsigned x, unsigned& nloc, unsigned& nx) {
    const unsigned G = gridDim.x * gridDim.y * gridDim.z;
    unsigned sum, cnt, mine, sp = 0u;
    for (;;) {
        sum = 0u; cnt = 0u; mine = 0u;
#pragma unroll
        for (unsigned j = 0; j < 16; ++j) { const unsigned c = xb_ld(&bar[XB_XCNT(j)]); sum += c; cnt += (c > 0u) ? 1u : 0u; mine = (j == x) ? c : mine; }
        if (sum == G) break;
        __builtin_amdgcn_s_sleep(1);
        if ((++sp & 255u) == 0u) { if (xb_ld(&bar[XB_TMO])) break; if (sp > XB_SPIN_CAP) { atomicAdd(&bar[XB_TMO], 1u); break; } }
    }
    nloc = mine > 0u ? mine : 1u; nx = cnt > 0u ? cnt : 1u;
}

__device__ __forceinline__ void xcd_barrier(const XcdBarrier& b) {
    asm volatile("s_waitcnt vmcnt(0)" ::: "memory");
    __syncthreads();
    if (threadIdx.x == 0) {
        unsigned* bar = b.bar;
        __builtin_amdgcn_s_waitcnt(0);
        unsigned nloc = b.st[0], nx = b.st[1];
        if (nloc == 0u) { xcd_barrier_complete(bar, b.x, nloc, nx); b.st[0] = nloc; b.st[1] = nx; }
        const unsigned old = xb_add(&bar[XB_XSUB(b.x)], 1u);
        const unsigned gen = old / nloc;
        if (old + 1u == (gen + 1u) * nloc) {
            __builtin_amdgcn_fence(__ATOMIC_RELEASE, "agent");
            asm volatile("s_waitcnt vmcnt(0)" ::: "memory");
            const unsigned og = xb_add(&bar[XB_TOP], 1u);
            const unsigned tg = og / nx;
            if (og + 1u == (tg + 1u) * nx) xb_add(&bar[XB_TOPGEN], 1u);
            else XB_SPIN(xb_ld(&bar[XB_TOPGEN]) == tg, bar);
            __builtin_amdgcn_fence(__ATOMIC_ACQUIRE, "agent");
            xb_add(&bar[XB_XGEN(b.x)], 1u);
            asm volatile("s_waitcnt vmcnt(0)" ::: "memory");
        } else {
            XB_SPIN(xb_ld(&bar[XB_XGEN(b.x)]) == gen, bar);
            __builtin_amdgcn_fence(__ATOMIC_ACQUIRE, "agent");
            asm volatile("s_waitcnt vmcnt(0)" ::: "memory");
        }
    }
    __syncthreads();
}

typedef float f32x16 __attribute__((ext_vector_type(16)));
typedef short s16x4 __attribute__((ext_vector_type(4)));
typedef unsigned u32x2 __attribute__((ext_vector_type(2)));
__device__ __forceinline__ unsigned cvtpk(float lo, float hi) { unsigned r; asm volatile("v_cvt_pk_bf16_f32 %0, %1, %2" : "=v"(r) : "v"(lo), "v"(hi)); return r; }
__device__ __forceinline__ float bflo(unsigned u) { return __builtin_bit_cast(float, u << 16); }
__device__ __forceinline__ float bfhi(unsigned u) { return __builtin_bit_cast(float, u & 0xffff0000u); }
__device__ __forceinline__ s16x4 vtr(const LAS unsigned char* p) { return __builtin_bit_cast(s16x4, __builtin_amdgcn_ds_read_tr16_b64_v4i16((LAS s16x4*)p)); }

struct Frame {
    LAS unsigned char* lds;
    int tid, lane, wave, G;
    const float *x, *norm1_g, *w_in, *conv_w, *ln_g, *ln_b, *gws, *gbs, *on_conv_g, *on_gmlp_g, *w_out, *norm2_g, *w_up, *w_down, *final_g;
    float* out;
    bf16 *Win_t, *Wout_t, *Wup_t, *Wdn_t, *Wsb, *X1B, *A2, *H, *P, *Y;
    float *rowsq2, *rowsq3;
};
__device__ __forceinline__ float wave_sum(float v) {
#pragma unroll
    for (int o = 1; o < 64; o <<= 1) v += __shfl_xor(v, o);
    return v;
}
__device__ __forceinline__ void p0_transpose_item(const float* W, int K, int N, const float* gk, bf16* WT, int drow0, LAS float* scr, int k0, int n0, int lane) {
#pragma unroll 8
    for (int i = 0; i < 32; ++i) { const int kk = 2 * i + (lane >> 5); float v = W[(size_t)(k0 + kk) * N + n0 + (lane & 31)]; if (gk) v *= gk[k0 + kk]; scr[kk * 33 + (lane & 31)] = v; }
    LDS_WAIT(); asm volatile("" ::: "memory");
    const int c = lane & 7;
#pragma unroll
    for (int j = 0; j < 4; ++j) { const int n = (lane >> 3) + 8 * j; const LAS float* s = scr + (8 * c) * 33 + n;
        v4u o; o.x = pk2(s[0 * 33], s[1 * 33]); o.y = pk2(s[2 * 33], s[3 * 33]); o.z = pk2(s[4 * 33], s[5 * 33]); o.w = pk2(s[6 * 33], s[7 * 33]);
        *(GAS v4u*)(WT + (size_t)(drow0 + n) * K + k0 + 8 * c) = o; }
    LDS_WAIT(); asm volatile("" ::: "memory");
}
__device__ __forceinline__ int map_in(int n) {
    if (n < 512) return 1024 + n;
    if (n < 1024) { const int c = n - 512; return (c >> 7) * 256 + (c & 127); }
    if (n < 1536) { const int c = n - 1024; return (c >> 7) * 256 + 128 + (c & 127); }
    return n;
}
__device__ __forceinline__ void rms_row_to_bf16(const float* xrow, bf16* orow, int lane) {
    const GAS f32x4* xr = (const GAS f32x4*)xrow + lane;
    f32x4 v[4]; float s = 0.f;
#pragma unroll
    for (int j = 0; j < 4; ++j) { v[j] = xr[64 * j]; s += (v[j].x * v[j].x + v[j].y * v[j].y) + (v[j].z * v[j].z + v[j].w * v[j].w); }
    const float rstd = 1.f / sqrtf(wave_sum(s) * (1.f / D) + EPS);
    GAS unsigned long long* o8 = (GAS unsigned long long*)orow + lane;
#pragma unroll
    for (int j = 0; j < 4; ++j) o8[64 * j] = (unsigned long long)cvtpk(v[j].x * rstd, v[j].y * rstd) | ((unsigned long long)cvtpk(v[j].z * rstd, v[j].w * rstd) << 32);
}
__device__ __forceinline__ void p0_prologue(Frame& F) {
    LAS float* scr = (LAS float*)(F.lds + RING_OFF + F.wave * 16384);
    const int gw = blockIdx.x * NWAVES + F.wave, NGW = F.G * NWAVES;
    constexpr int I_IN = (D / 64) * (NIN / 32), I_OUT = (D / 64) * (D / 32), I_UP = (D / 64) * (FF / 32), I_DN = (FF / 64) * (D / 32);
    constexpr int NITEMS = I_IN + I_OUT + I_UP + I_DN;
    for (int it = gw; it < NITEMS; it += NGW) {
        int r = it;
        if (r < I_IN) { const int nb = NIN / 32, k0 = 64 * (r / nb), n0 = 32 * (r % nb); p0_transpose_item(F.w_in, D, NIN, F.norm1_g, F.Win_t, map_in(n0), scr, k0, n0, F.lane); continue; } r -= I_IN;
        if (r < I_OUT) { const int nb = D / 32, k0 = 64 * (r / nb), n0 = 32 * (r % nb); p0_transpose_item(F.w_out, D, D, (k0 < 512) ? F.on_conv_g : (F.on_gmlp_g - 512), F.Wout_t, n0, scr, k0, n0, F.lane); continue; } r -= I_OUT;
        if (r < I_UP) { const int nb = FF / 32, k0 = 64 * (r / nb), n0 = 32 * (r % nb); p0_transpose_item(F.w_up, D, FF, F.norm2_g, F.Wup_t, n0, scr, k0, n0, F.lane); continue; } r -= I_UP;
        { const int nb = D / 32, k0 = 64 * (r / nb), n0 = 32 * (r % nb); p0_transpose_item(F.w_down, FF, D, nullptr, F.Wdn_t, n0, scr, k0, n0, F.lane); }
    }
    for (int t = blockIdx.x * (NWAVES * 64) + F.tid; t < 8 * 128 * 128 / 8; t += F.G * NWAVES * 64) {
        const int base = t * 8, i = (base >> 7) & 127, j0 = base & 127; const bool keep = !((j0 >= 64) && (i < 64));
        const f32x4 a = *(const f32x4*)(F.gws + base), b = *(const f32x4*)(F.gws + base + 4);
        v4u o; o.x = pk2(a.x, a.y); o.y = pk2(a.z, a.w); o.z = pk2(b.x, b.y); o.w = pk2(b.z, b.w);
        if (!keep) o = (v4u){0u, 0u, 0u, 0u};
        *(GAS v4u*)(F.Wsb + base) = o;
    }
    for (int m = gw; m < M; m += NGW) rms_row_to_bf16(F.x + (size_t)m * D, F.H + (size_t)m * D, F.lane);
}
__device__ __forceinline__ void p2_conv_rows(Frame& F, int t0) {
    int lane = F.lane; asm volatile("" : "+v"(lane));
    float w0[8], w1[8], w2[8];
    { const float* cw = F.conv_w + 24 * lane;
#pragma unroll
      for (int e = 0; e < 8; ++e) { w0[e] = cw[3 * e + 0]; w1[e] = cw[3 * e + 1]; w2[e] = cw[3 * e + 2]; } }
    float z2[8], z1[8];
    if ((t0 & (SEQ - 1)) == 0) {
#pragma unroll
        for (int e = 0; e < 8; ++e) { z2[e] = 0.f; z1[e] = 0.f; }
    } else {
        const v4u a = *(const GAS v4u*)(F.P + (size_t)(t0 - 2) * PW + P_Z + 8 * lane), b = *(const GAS v4u*)(F.P + (size_t)(t0 - 1) * PW + P_Z + 8 * lane);
        z2[0] = bflo(a.x); z2[1] = bfhi(a.x); z2[2] = bflo(a.y); z2[3] = bfhi(a.y); z2[4] = bflo(a.z); z2[5] = bfhi(a.z); z2[6] = bflo(a.w); z2[7] = bfhi(a.w);
        z1[0] = bflo(b.x); z1[1] = bfhi(b.x); z1[2] = bflo(b.y); z1[3] = bfhi(b.y); z1[4] = bflo(b.z); z1[5] = bfhi(b.z); z1[6] = bflo(b.w); z1[7] = bfhi(b.w);
    }
#pragma unroll
    for (int half = 0; half < 2; ++half) {
        v4u zr[8], br[8];
#pragma unroll
        for (int rr = 0; rr < 8; ++rr) { const size_t t = (size_t)(t0 + half * 8 + rr); zr[rr] = *(const GAS v4u*)(F.P + t * PW + P_Z + 8 * lane); br[rr] = *(const GAS v4u*)(F.P + t * PW + P_B + 8 * lane); }
#pragma unroll
        for (int rr = 0; rr < 8; ++rr) {
            float z0[8], bb[8], y[8];
            z0[0] = bflo(zr[rr].x); z0[1] = bfhi(zr[rr].x); z0[2] = bflo(zr[rr].y); z0[3] = bfhi(zr[rr].y); z0[4] = bflo(zr[rr].z); z0[5] = bfhi(zr[rr].z); z0[6] = bflo(zr[rr].w); z0[7] = bfhi(zr[rr].w);
            bb[0] = bflo(br[rr].x); bb[1] = bfhi(br[rr].x); bb[2] = bflo(br[rr].y); bb[3] = bfhi(br[rr].y); bb[4] = bflo(br[rr].z); bb[5] = bfhi(br[rr].z); bb[6] = bflo(br[rr].w); bb[7] = bfhi(br[rr].w);
            float ss = 0.f;
#pragma unroll
            for (int e = 0; e < 8; ++e) { y[e] = bb[e] * (w0[e] * z2[e] + w1[e] * z1[e] + w2[e] * z0[e]); ss += y[e] * y[e]; }
            const float rstd = 1.f / sqrtf(wave_sum(ss) * (1.f / 512.f) + EPS);
            v4u o; o.x = cvtpk(y[0] * rstd, y[1] * rstd); o.y = cvtpk(y[2] * rstd, y[3] * rstd); o.z = cvtpk(y[4] * rstd, y[5] * rstd); o.w = cvtpk(y[6] * rstd, y[7] * rstd);
            *(GAS v4u*)(F.Y + (size_t)(t0 + half * 8 + rr) * D + 8 * lane) = o;
#pragma unroll
            for (int e = 0; e < 8; ++e) { z2[e] = z1[e]; z1[e] = z0[e]; }
        }
    }
}
__device__ __forceinline__ void p2_gmlp_item(Frame& F, int g) {
    int lane = F.lane; asm volatile("" : "+v"(lane)); const int w = F.wave;
    LAS unsigned char* vl = F.lds + RING_OFF;
    LAS float* part = (LAS float*)(F.lds + PART_OFF);
    const size_t rbase = (size_t)g * 128;
    {
        const f32x4 g0 = *(const f32x4*)(F.ln_g + 8 * lane), g1 = *(const f32x4*)(F.ln_g + 8 * lane + 4), b0 = *(const f32x4*)(F.ln_b + 8 * lane), b1 = *(const f32x4*)(F.ln_b + 8 * lane + 4);
        v4u raw[16];
#pragma unroll
        for (int rr = 0; rr < 16; ++rr) raw[rr] = *(const GAS v4u*)(F.P + (rbase + 16 * w + rr) * PW + P_V + 8 * lane);
#pragma unroll
        for (int rr = 0; rr < 16; ++rr) {
            float xv[8];
            xv[0] = bflo(raw[rr].x); xv[1] = bfhi(raw[rr].x); xv[2] = bflo(raw[rr].y); xv[3] = bfhi(raw[rr].y); xv[4] = bflo(raw[rr].z); xv[5] = bfhi(raw[rr].z); xv[6] = bflo(raw[rr].w); xv[7] = bfhi(raw[rr].w);
            float s = ((xv[0] + xv[1]) + (xv[2] + xv[3])) + ((xv[4] + xv[5]) + (xv[6] + xv[7]));
            const float mean = wave_sum(s) * (1.f / 512.f);
            float q = 0.f;
#pragma unroll
            for (int e = 0; e < 8; ++e) { xv[e] -= mean; q += xv[e] * xv[e]; }
            const float rstd = 1.f / sqrtf(wave_sum(q) * (1.f / 512.f) + EPS);
            v4u o;
            o.x = cvtpk(xv[0] * rstd * g0.x + b0.x, xv[1] * rstd * g0.y + b0.y); o.y = cvtpk(xv[2] * rstd * g0.z + b0.z, xv[3] * rstd * g0.w + b0.w);
            o.z = cvtpk(xv[4] * rstd * g1.x + b1.x, xv[5] * rstd * g1.y + b1.y); o.w = cvtpk(xv[6] * rstd * g1.z + b1.z, xv[7] * rstd * g1.w + b1.w);
            *(LAS v4u*)(vl + (16 * w + rr) * VSTR + 16 * lane) = o;
        }
    }
    __syncthreads();
    const int h = w, r = lane & 31, hh = lane >> 5;
    f32x16 acc[2][4];
#pragma unroll
    for (int dt = 0; dt < 2; ++dt)
#pragma unroll
        for (int it = 0; it < 4; ++it)
#pragma unroll
            for (int e = 0; e < 16; ++e) acc[dt][it][e] = 0.f;
    {
        const LAS unsigned char* tb = vl + (8 * hh + ((lane & 15) >> 2)) * VSTR + (64 * h + 16 * ((lane >> 4) & 1) + 4 * (lane & 3)) * 2;
        const bf16* Wh = F.Wsb + (size_t)h * 128 * 128 + (size_t)r * 128 + 8 * hh;
#pragma unroll
        for (int it = 0; it < 4; ++it) {
            constexpr int dummy = 0; (void)dummy;
            const int nks = (it < 2) ? 4 : 8;
            bf16x8 wf[8];
#pragma unroll
            for (int ks = 0; ks < 8; ++ks) if (ks < nks) wf[ks] = *(const GAS bf16x8*)(Wh + (size_t)(32 * it) * 128 + 16 * ks);
#pragma unroll
            for (int ks = 0; ks < 8; ++ks) if (ks < nks) {
#pragma unroll
                for (int dt = 0; dt < 2; ++dt) {
                    const s16x4 lo = vtr(tb + (16 * ks) * VSTR + 64 * dt), hi = vtr(tb + (16 * ks + 4) * VSTR + 64 * dt);
                    const bf16x8 vf = (bf16x8){lo[0], lo[1], lo[2], lo[3], hi[0], hi[1], hi[2], hi[3]};
                    acc[dt][it] = __builtin_amdgcn_mfma_f32_32x32x16_bf16(vf, wf[ks], acc[dt][it], 0, 0, 0);
                }
            }
        }
    }
    float ssq[4];
#pragma unroll
    for (int it = 0; it < 4; ++it) {
        const int i = 32 * it + r; const float bias = F.gbs[h * 128 + i];
        const bf16* up = F.P + (rbase + i) * PW + P_U + 64 * h + 4 * hh;
        u32x2 uu[2][4];
#pragma unroll
        for (int dt = 0; dt < 2; ++dt)
#pragma unroll
            for (int q = 0; q < 4; ++q) uu[dt][q] = *(const GAS u32x2*)(up + 32 * dt + 8 * q);
        float ss = 0.f;
#pragma unroll
        for (int dt = 0; dt < 2; ++dt)
#pragma unroll
            for (int q = 0; q < 4; ++q) {
                const float u0 = bflo(uu[dt][q].x), u1 = bfhi(uu[dt][q].x), u2 = bflo(uu[dt][q].y), u3 = bfhi(uu[dt][q].y);
                const float y0 = u0 * (acc[dt][it][4 * q + 0] + bias), y1 = u1 * (acc[dt][it][4 * q + 1] + bias), y2 = u2 * (acc[dt][it][4 * q + 2] + bias), y3 = u3 * (acc[dt][it][4 * q + 3] + bias);
                acc[dt][it][4 * q + 0] = y0; acc[dt][it][4 * q + 1] = y1; acc[dt][it][4 * q + 2] = y2; acc[dt][it][4 * q + 3] = y3;
                ss += (y0 * y0 + y1 * y1) + (y2 * y2 + y3 * y3);
            }
        ss += __shfl_xor(ss, 32);
        ssq[it] = ss;
        if (hh == 0) part[i * 8 + h] = ss;
    }
    __syncthreads();
#pragma unroll
    for (int it = 0; it < 4; ++it) {
        const int i = 32 * it + r;
        const f32x4 pa = *(const LAS f32x4*)(part + i * 8), pb = *(const LAS f32x4*)(part + i * 8 + 4);
        const float tot = ((pa.x + pa.y) + (pa.z + pa.w)) + ((pb.x + pb.y) + (pb.z + pb.w));
        const float rstd = 1.f / sqrtf(tot * (1.f / 512.f) + EPS);
        bf16* yp = F.Y + (rbase + i) * D + 512 + 64 * h + 4 * hh;
#pragma unroll
        for (int dt = 0; dt < 2; ++dt)
#pragma unroll
            for (int q = 0; q < 4; ++q) { u32x2 o; o.x = cvtpk(acc[dt][it][4 * q + 0] * rstd, acc[dt][it][4 * q + 1] * rstd); o.y = cvtpk(acc[dt][it][4 * q + 2] * rstd, acc[dt][it][4 * q + 3] * rstd);
                *(GAS u32x2*)(yp + 32 * dt + 8 * q) = o; }
    }
    (void)ssq;
    __syncthreads();
}
__device__ __forceinline__ void p2_mixers(Frame& F) {
    for (int g = blockIdx.x; g < M / 128; g += F.G) {
        p2_conv_rows(F, g * 128 + F.wave * 16);
        p2_gmlp_item(F, g);
    }
}
__device__ __forceinline__ void p6_final(Frame& F, bool poison) {
    const int gw = blockIdx.x * NWAVES + F.wave, NGW = F.G * NWAVES;
    int lane = F.lane; asm volatile("" : "+v"(lane));
    f32x4 gg[4];
#pragma unroll
    for (int j = 0; j < 4; ++j) gg[j] = *(const f32x4*)(F.final_g + 4 * lane + 256 * j);
    const float qnan = __builtin_nanf("");
    for (int m = gw; m < M; m += NGW) {
        GAS f32x4* xr = (GAS f32x4*)(F.out + (size_t)m * D) + lane;
        f32x4 v[4];
#pragma unroll
        for (int j = 0; j < 4; ++j) v[j] = xr[64 * j];
        const float s = __hip_atomic_load(F.rowsq3 + m, __ATOMIC_RELAXED, __HIP_MEMORY_SCOPE_AGENT);
        float rstd = 1.f / sqrtf(s * (1.f / D) + EPS);
        if (poison) rstd = qnan;
#pragma unroll
        for (int j = 0; j < 4; ++j) xr[64 * j] = v[j] * rstd * gg[j];
    }
}
struct Args { const float* in[15]; float* out; unsigned char* ws; int ph_lo, ph_hi; };
__global__ void __launch_bounds__(NWAVES * 64, 2) hyb_fwd(Args args) {
    extern __shared__ __attribute__((aligned(16))) unsigned char lds[];
    Frame F;
    F.lds = (LAS unsigned char*)lds;
    volatile LAS unsigned* MISC = (volatile LAS unsigned*)(F.lds + MISC_OFF);
    F.tid = threadIdx.x; F.lane = F.tid & 63; F.wave = __builtin_amdgcn_readfirstlane(F.tid >> 6);
    F.G = gridDim.x;
    unsigned char* ws = args.ws;
    gu32* ctl = (gu32*)(ws + WS_CTL);
    F.x = args.in[0]; F.norm1_g = args.in[1]; F.w_in = args.in[2]; F.conv_w = args.in[3]; F.ln_g = args.in[4]; F.ln_b = args.in[5]; F.gws = args.in[6]; F.gbs = args.in[7];
    F.on_conv_g = args.in[8]; F.on_gmlp_g = args.in[9]; F.w_out = args.in[10]; F.norm2_g = args.in[11]; F.w_up = args.in[12]; F.w_down = args.in[13]; F.final_g = args.in[14];
    F.out = args.out;
    F.Win_t = (bf16*)(ws + WS_WIN); F.Wout_t = (bf16*)(ws + WS_WOUT); F.Wup_t = (bf16*)(ws + WS_WUP); F.Wdn_t = (bf16*)(ws + WS_WDN); F.Wsb = (bf16*)(ws + WS_WSB);
    F.X1B = (bf16*)(ws + WS_X1B); F.A2 = (bf16*)(ws + WS_A2); F.H = (bf16*)(ws + WS_H); F.P = (bf16*)(ws + WS_P); F.Y = (bf16*)(ws + WS_Y);
    F.rowsq2 = (float*)(ws + WS_CTL + CTL_ROWSQ2); F.rowsq3 = (float*)(ws + WS_CTL + CTL_ROWSQ3);
    for (int u = F.tid; u < 128; u += NWAVES * 64) MISC[u] = 0u;
    __syncthreads();
    XcdBarrier bar; bar.bar = (unsigned*)(ctl + CW_BAR); bar.x = 0; bar.st = nullptr;
    if (N_LAUNCHES != PER_PHASE) bar = xcd_barrier_post((unsigned*)(ctl + CW_BAR), MISC + 8);
#define GRID_BAR() do { if (N_LAUNCHES != PER_PHASE) xcd_barrier(bar); } while (0)
    const int lo = args.ph_lo, hi = args.ph_hi;
#define IN(k) (lo <= (k) && (k) < hi)
#define BOTH(k) (IN(k) && IN((k) + 1))

    if (IN(0)) { p0_prologue(F); if (BOTH(0)) GRID_BAR(); }

    if (IN(1)) {
        pg8::Gemm g{F.H, F.Win_t, M, NIN, D}; pg8::StaticOrder S; S.init(M, NIN, F.G, (int)blockIdx.x);
        pg8::EpiIn E{F.P};
        pg8::gemm_phase<pg8::EpiIn, pg8::StaticOrder, true, true>(F.lds + RING_OFF, g, S, E);
        if (BOTH(1)) GRID_BAR();
    }
    if (IN(2)) { p2_mixers(F); if (BOTH(2)) GRID_BAR(); }

    if (IN(3)) {
        pg8::Gemm g{F.Y, F.Wout_t, M, D, D}; pg8::StaticOrder S; S.init(M, D, F.G, (int)blockIdx.x);
        pg8::EpiRes<true> E{F.x, F.out, F.X1B, F.rowsq2};
        pg8::gemm_phase<pg8::EpiRes<true>, pg8::StaticOrder, true, true>(F.lds + RING_OFF, g, S, E);
        if (BOTH(3)) GRID_BAR();
    }
    if (IN(4)) {
        pg8::Gemm g{F.X1B, F.Wup_t, M, FF, D}; pg8::StaticOrder S; S.init(M, FF, F.G, (int)blockIdx.x);
        pg8::EpiUp E{F.A2, F.rowsq2, EPS};
        pg8::gemm_phase<pg8::EpiUp, pg8::StaticOrder, true, true>(F.lds + RING_OFF, g, S, E);
        if (BOTH(4)) GRID_BAR();
    }
    if (IN(5)) {
        pg8::Gemm g{F.A2, F.Wdn_t, M, D, FF}; pg8::StaticOrder S; S.init(M, D, F.G, (int)blockIdx.x);
        pg8::EpiRes<false> E{F.out, F.out, nullptr, F.rowsq3};
        pg8::gemm_phase<pg8::EpiRes<false>, pg8::StaticOrder, true, true>(F.lds + RING_OFF, g, S, E);
        if (BOTH(5)) GRID_BAR();
    }
    if (IN(6)) {
        bool poison = false;
        if (N_LAUNCHES != PER_PHASE) poison = __hip_atomic_load(ctl + CW_BAR + XB_TMO, RLX_AGENT) != 0u;
        p6_final(F, poison);
    }
#undef IN
#undef BOTH
}

extern "C" void kernel_launch(void* const* d_in, const int* in_sizes, int n_in, void* d_out, int out_size, void* d_ws, size_t ws_size, hipStream_t stream) {
    static int grid = 0;
    if (grid == 0) {
        if (n_in != 15 || in_sizes[0] != M * D || out_size != M * D || ws_size < WS_END) { fprintf(stderr, "kernel_launch: shape/workspace mismatch (n_in %d, in0 %d, out %d, ws %zu); nothing launched\n", n_in, n_in > 0 ? in_sizes[0] : -1, out_size, ws_size); grid = -1; return; }
        int dev = 0, cus = 0, per_cu = 0;
        if (hipGetDevice(&dev) != hipSuccess || hipDeviceGetAttribute(&cus, hipDeviceAttributeMultiprocessorCount, dev) != hipSuccess) { fprintf(stderr, "kernel_launch: device query failed\n"); grid = -1; return; }
        if (hipFuncSetAttribute((const void*)hyb_fwd, hipFuncAttributeMaxDynamicSharedMemorySize, LDS_BYTES) != hipSuccess) { fprintf(stderr, "kernel_launch: hipFuncSetAttribute failed\n"); grid = -1; return; }
        if (hipOccupancyMaxActiveBlocksPerMultiprocessor(&per_cu, (const void*)hyb_fwd, NWAVES * 64, LDS_BYTES) != hipSuccess || per_cu < 1)
            fprintf(stderr, "kernel_launch: note: occupancy query reports %d workgroups per CU\n", per_cu);
        (void)hipGetLastError();
        grid = cus;
        if (grid > 256) grid = 256;
    }
    if (grid < 0) return;
    if (hipMemsetAsync((char*)d_ws + WS_CTL, 0, CTL_ZERO_BYTES, stream) != hipSuccess) { fprintf(stderr, "kernel_launch: hipMemsetAsync failed\n"); return; }
    Args a{};
    for (int i = 0; i < 15; ++i) a.in[i] = (const float*)d_in[i];
    a.out = (float*)d_out; a.ws = (unsigned char*)d_ws;
    for (int li = 0; li < N_LAUNCHES; ++li) {
        a.ph_lo = (N_LAUNCHES == PER_PHASE) ? li : 0; a.ph_hi = (N_LAUNCHES == PER_PHASE) ? li + 1 : PER_PHASE;
        hipLaunchKernelGGL(hyb_fwd, dim3(grid), dim3(NWAVES * 64), LDS_BYTES, stream, a);
        const hipError_t le = hipPeekAtLastError();
        if (le != hipSuccess) { fprintf(stderr, "kernel_launch: launch %d failed: %s\n", li, hipGetErrorName(le)); break; }
    }
}
```
